# Optimizing an MI355X kernel written in HIP

```python
import math
import jax, jax.numpy as jnp
from jax import lax
import numpy as np

D_MODEL = 1024
BATCH = 16
SEQ = 2048
DEPTH = 4

HEAD_DIM = 64
ROT_DIM = HEAD_DIM // 4
ROPE_THETA = 500000.0

A_Q_HEADS = 8
A_KV_HEADS = 2
A_WINDOW = 128

B_GROUPS = ((128, 1), (512, 4), (2048, 16))
N_B_GROUPS = 3
B_HEADS_PER_GROUP = 4

D_FF = 4 * D_MODEL
PLE_DIM = 256
N_BRANCHES = 2
LN_EPS = 1e-5
DEEPNORM_ALPHA = (2 * DEPTH) ** 0.25
DEEPNORM_BETA = (8 * DEPTH) ** -0.25

A_Q_W = A_Q_HEADS * HEAD_DIM
A_KV_W = A_KV_HEADS * HEAD_DIM
B_HEADS = N_B_GROUPS * B_HEADS_PER_GROUP
B_W = B_HEADS * HEAD_DIM
B_OUT_W = B_HEADS_PER_GROUP * HEAD_DIM
GATE_W = N_BRANCHES * D_MODEL
D_IN = A_Q_W + 2 * A_KV_W + 3 * B_W + GATE_W
IN_SPLITS = (A_Q_W, A_Q_W + A_KV_W, A_Q_W + 2 * A_KV_W,
             A_Q_W + 2 * A_KV_W + B_W, A_Q_W + 2 * A_KV_W + 2 * B_W,
             A_Q_W + 2 * A_KV_W + 3 * B_W)

kernel_name = "hybrid_gated_window_dilated_encoder"


def _layer_norm(x, g, b):
    xf = x.astype(jnp.float32)
    mu = jnp.mean(xf, axis=-1, keepdims=True)
    var = jnp.mean(jnp.square(xf - mu), axis=-1, keepdims=True)
    y = (xf - mu) * lax.rsqrt(var + LN_EPS) * g.astype(jnp.float32) + b.astype(jnp.float32)
    return y.astype(x.dtype)


def _rope_tables(seq):
    pos = jnp.arange(seq, dtype=jnp.float32)
    inv_freq = ROPE_THETA ** (-jnp.arange(0, ROT_DIM, 2, dtype=jnp.float32) / ROT_DIM)
    ang = pos[:, None] * inv_freq[None, :]
    return jnp.cos(ang), jnp.sin(ang)


def _rope(t, cos, sin):
    half = ROT_DIM // 2
    tf = t.astype(jnp.float32)
    t1, t2 = tf[..., :half], tf[..., half:ROT_DIM]
    c, s = cos[:, None, :], sin[:, None, :]
    out = jnp.concatenate([t1 * c - t2 * s, t2 * c + t1 * s, tf[..., ROT_DIM:]], axis=-1)
    return out.astype(t.dtype)


def _banded_attention(q, k, v, window, sink=None):
    n, seq, hq, dh = q.shape
    hkv = k.shape[2]
    grp = hq // hkv
    bs = window
    nblk = -(-seq // bs)
    lp = nblk * bs
    scale = 1.0 / math.sqrt(dh)
    qp = jnp.pad(q, ((0, 0), (0, lp - seq), (0, 0), (0, 0)))
    kp = jnp.pad(k, ((0, 0), (bs, lp - seq + bs), (0, 0), (0, 0))).astype(jnp.float32)
    vp = jnp.pad(v, ((0, 0), (bs, lp - seq + bs), (0, 0), (0, 0))).astype(jnp.float32)
    qb = qp.reshape(n, nblk, bs, hkv, grp, dh).transpose(1, 0, 2, 3, 4, 5)
    sink_b = None if sink is None else sink.astype(jnp.float32).reshape(1, hkv, grp, 1)

    def block(args):
        j, qj = args
        kj = lax.dynamic_slice_in_dim(kp, j * bs, 3 * bs, axis=1)
        vj = lax.dynamic_slice_in_dim(vp, j * bs, 3 * bs, axis=1)
        s = jnp.einsum('nqkgd,nskd->nkgqs', qj.astype(jnp.float32) * scale, kj)
        qpos = j * bs + jnp.arange(bs)
        kpos = j * bs - bs + jnp.arange(3 * bs)
        mask = (jnp.abs(qpos[:, None] - kpos[None, :]) <= window) & (kpos >= 0)[None, :] & (kpos < seq)[None, :]
        s = jnp.where(mask, s, -jnp.inf)
        m = jnp.max(s, axis=-1)
        if sink_b is not None:
            m = jnp.maximum(m, sink_b)
        e = jnp.exp(s - m[..., None])
        denom = jnp.sum(e, axis=-1)
        if sink_b is not None:
            denom = denom + jnp.exp(sink_b - m)
        o = jnp.einsum('nkgqs,nskd->nqkgd', e, vj) / denom.transpose(0, 3, 1, 2)[..., None]
        lse = (m + jnp.log(denom)).transpose(0, 3, 1, 2)
        return o, lse

    o, lse = lax.map(block, (jnp.arange(nblk), qb))
    o = o.transpose(1, 0, 2, 3, 4, 5).reshape(n, lp, hq, dh)[:, :seq].astype(q.dtype)
    lse = lse.transpose(1, 0, 2, 3, 4).reshape(n, lp, hq)[:, :seq]
    return o, lse


def _dilated_attention(q, k, v, window, dilation):
    n, seq, h, dh = q.shape
    r = dilation

    def sub(t):
        return t.reshape(n, seq // r, r, h, dh).transpose(0, 2, 1, 3, 4).reshape(n * r, seq // r, h, dh)

    o, lse = _banded_attention(sub(q), sub(k), sub(v), (window // 2) // r)
    o = o.reshape(n, r, seq // r, h, dh).transpose(0, 2, 1, 3, 4).reshape(n, seq, h, dh)
    lse = lse.reshape(n, r, seq // r, h).transpose(0, 2, 1, 3).reshape(n, seq, h)
    return o, lse


def _mixer_sublayer(x, cos, sin, w_in, b_gate, a_sink, w_branch_a, w_branch_b, w_out):
    bsz, seq, _ = x.shape
    proj = jnp.einsum('bsd,de->bse', x, w_in)
    qa, ka, va, qb, kb, vb, gl = jnp.split(proj, IN_SPLITS, axis=-1)

    qa = _rope(qa.reshape(bsz, seq, A_Q_HEADS, HEAD_DIM), cos, sin)
    ka = _rope(ka.reshape(bsz, seq, A_KV_HEADS, HEAD_DIM), cos, sin)
    va = va.reshape(bsz, seq, A_KV_HEADS, HEAD_DIM)
    oa, _ = _banded_attention(qa, ka, va, A_WINDOW, a_sink)
    ya = jnp.einsum('bse,ed->bsd', oa.reshape(bsz, seq, A_Q_W), w_branch_a)

    qb = _rope(qb.reshape(bsz, seq, B_HEADS, HEAD_DIM), cos, sin)
    kb = _rope(kb.reshape(bsz, seq, B_HEADS, HEAD_DIM), cos, sin)
    vb = vb.reshape(bsz, seq, B_HEADS, HEAD_DIM)
    outs, lses = [], []
    for g, (window, dil) in enumerate(B_GROUPS):
        hs = slice(g * B_HEADS_PER_GROUP, (g + 1) * B_HEADS_PER_GROUP)
        o, lse = _dilated_attention(qb[:, :, hs], kb[:, :, hs], vb[:, :, hs], window, dil)
        outs.append(o)
        lses.append(lse)
    wts = jax.nn.softmax(jnp.stack(lses), axis=0)
    ob = jnp.einsum('gbsh,gbshd->bshd', wts, jnp.stack(outs).astype(jnp.float32)).astype(x.dtype)
    yb = jnp.einsum('bse,ed->bsd', ob.reshape(bsz, seq, B_OUT_W), w_branch_b)

    gates = jax.nn.sigmoid((gl + b_gate).astype(jnp.float32)).astype(x.dtype)
    ga, gb = jnp.split(gates, N_BRANCHES, axis=-1)
    return jnp.einsum('bsd,de->bse', ga * ya + gb * yb, w_out)


def setup_inputs(seed: int = 0) -> dict:
    key = jax.random.key(seed)
    ks = jax.random.split(key, 24)
    L, D = DEPTH, D_MODEL
    beta = DEEPNORM_BETA

    def dense(k, shape, fan_in, scale=1.0):
        return jax.random.normal(k, shape, jnp.float32) * (scale * fan_in ** -0.5)

    x = jax.random.normal(ks[0], (BATCH, SEQ, D), jnp.float32)
    p = jax.random.normal(ks[1], (DEPTH, BATCH, SEQ, PLE_DIM), jnp.float32)
    w_in = jnp.concatenate([
        dense(ks[2], (L, D, A_Q_W), D),
        dense(ks[3], (L, D, A_KV_W), D),
        dense(ks[4], (L, D, A_KV_W), D, beta),
        dense(ks[5], (L, D, B_W), D),
        dense(ks[6], (L, D, B_W), D),
        dense(ks[7], (L, D, B_W), D, beta),
        dense(ks[8], (L, D, GATE_W), D),
    ], axis=-1)
    b_gate = 0.1 * jax.random.normal(ks[9], (L, GATE_W), jnp.float32)
    a_sink = 0.5 * jax.random.normal(ks[10], (L, A_Q_HEADS), jnp.float32)
    w_branch_a = dense(ks[11], (L, A_Q_W, D), A_Q_W, beta)
    w_branch_b = dense(ks[12], (L, B_OUT_W, D), B_OUT_W, beta)
    w_out = dense(ks[13], (L, D, D), D, beta)
    ln1_g = 1.0 + 0.02 * jax.random.normal(ks[14], (L, D), jnp.float32)
    ln1_b = 0.02 * jax.random.normal(ks[15], (L, D), jnp.float32)
    w_up = dense(ks[16], (L, D, D_FF), D)
    w_down = dense(ks[17], (L, D_FF, D), D_FF, beta)
    w_ple_gate = dense(ks[18], (L, D, D), D)
    b_ple_gate = 0.1 * jax.random.normal(ks[19], (L, D), jnp.float32)
    w_ple = dense(ks[20], (L, PLE_DIM, D), PLE_DIM, beta)
    ln2_g = 1.0 + 0.02 * jax.random.normal(ks[21], (L, D), jnp.float32)
    ln2_b = 0.02 * jax.random.normal(ks[22], (L, D), jnp.float32)
    return {"x": x, "p": p, "w_in": w_in, "b_gate": b_gate, "a_sink": a_sink,
            "w_branch_a": w_branch_a, "w_branch_b": w_branch_b, "w_out": w_out,
            "ln1_g": ln1_g, "ln1_b": ln1_b, "w_up": w_up, "w_down": w_down,
            "w_ple_gate": w_ple_gate, "b_ple_gate": b_ple_gate, "w_ple": w_ple,
            "ln2_g": ln2_g, "ln2_b": ln2_b}


def reference(x, p, w_in, b_gate, a_sink, w_branch_a, w_branch_b, w_out,
              ln1_g, ln1_b, w_up, w_down, w_ple_gate, b_ple_gate, w_ple,
              ln2_g, ln2_b):
    cos, sin = _rope_tables(x.shape[1])
    for i in range(DEPTH):
        h = _mixer_sublayer(x, cos, sin, w_in[i], b_gate[i], a_sink[i],
                            w_branch_a[i], w_branch_b[i], w_out[i])
        x = _layer_norm(DEEPNORM_ALPHA * x + h, ln1_g[i], ln1_b[i])
        mlp = jnp.einsum('bsf,fd->bsd', jnp.square(jax.nn.relu(jnp.einsum('bsd,df->bsf', x, w_up[i]))), w_down[i])
        gate = jax.nn.sigmoid((jnp.einsum('bsd,de->bse', x, w_ple_gate[i]) + b_ple_gate[i]).astype(jnp.float32)).astype(x.dtype)
        ple = gate * jnp.einsum('bsr,rd->bsd', p[i], w_ple[i])
        x = _layer_norm(DEEPNORM_ALPHA * x + mlp + ple, ln2_g[i], ln2_b[i])
    return x
```

```cpp
#include <hip/hip_runtime.h>
#include <hip/hip_cooperative_groups.h>
#include <cstdio>
#include <cstdint>
namespace cg = cooperative_groups;
namespace pg8 {
#define PG8_LAS __attribute__((address_space(3)))
typedef unsigned short bf16_t;
typedef short bf16x8 __attribute__((ext_vector_type(8)));
typedef float f32x4 __attribute__((ext_vector_type(4)));
typedef unsigned u32x4 __attribute__((ext_vector_type(4)));
constexpr int BM = 256, BK = 64, HALF = 128, HTB = HALF * BK * 2  , STAGE_BYTES = 8 * HTB, NXCD = 8, WGM = 8;

__host__ __device__ __forceinline__ int lds_byte(int r, int c) { const int st = (r >> 4) * 2 + (c >> 5), rr = r & 15, cc = c & 31, ob = rr * 64 + cc * 2; return st * 1024 + (ob ^ (((ob >> 9) & 1) << 5)); }
__host__ __device__ __forceinline__ void stage_rc(int b, int& R, int& C) { const int st = b / 1024, sb = b % 1024, swz = sb ^ (((sb >> 9) & 1) << 5); R = (st >> 1) * 16 + swz / 64; C = (st & 1) * 32 + (swz % 64) / 2; }
__host__ __device__ __forceinline__ int perm32(int rho) { const int n = rho >> 4, i = rho & 15; return 8 * (i >> 2) + 4 * n + (i & 3); }

struct Unit { int pm, pn; };
struct Gemm { const bf16_t* A; const bf16_t* Bt; int M, N, K, wave; };

struct StaticOrder {
    int nM, nN, nwg, G, c;
    __host__ __device__ void init(int M, int N, int G_, int c_) { nM = M / BM; nN = N / BM; nwg = nM * nN; G = G_; c = c_; }
    __host__ __device__ bool next(int i, Unit& u) const {
        const long L = (long)i * G + c; if (L >= nwg) return false;
        int wgid = (int)L; { const int q = nwg / NXCD, r = nwg % NXCD, xcd = wgid % NXCD, off = wgid / NXCD; wgid = (xcd < r ? xcd * (q + 1) : r * (q + 1) + (xcd - r) * q) + off; }
        const int nig = WGM * nN, gid = wgid / nig, fm = gid * WGM, gsz = (nM - fm) < WGM ? (nM - fm) : WGM;
        u.pm = fm + ((wgid % nig) % gsz); u.pn = (wgid % nig) / gsz; return true;
    }
    __device__ __forceinline__ void a_ready(const Unit&) const {}
    __device__ __forceinline__ void done(const Unit&) const {}
};

typedef float f32x2_cv __attribute__((ext_vector_type(2))); typedef __bf16 bf16x2_cv __attribute__((ext_vector_type(2)));
__device__ __forceinline__ unsigned cvt_pk_bf16(float lo, float hi) { f32x2_cv v = {lo, hi}; bf16x2_cv b = __builtin_convertvector(v, bf16x2_cv); return __builtin_bit_cast(unsigned, b); }
typedef float f32x2 __attribute__((ext_vector_type(2)));
typedef unsigned u32x2 __attribute__((ext_vector_type(2)));
template <int X> __device__ __forceinline__ float swz_xor(float v) { static_assert(X > 0 && X < 32, "ds_swizzle bit mode"); return __int_as_float(__builtin_amdgcn_ds_swizzle(__float_as_int(v), 0x1F | (X << 10))); }
__device__ __forceinline__ float bf_lo(unsigned w) { return __uint_as_float(w << 16); }
__device__ __forceinline__ float bf_hi(unsigned w) { return __uint_as_float(w & 0xffff0000u); }
__device__ __forceinline__ float sigmoid_f(float v) { return __builtin_amdgcn_rcpf(1.0f + __builtin_amdgcn_exp2f(-1.4426950408889634f * v)); }
constexpr float QSCALE = 0.18033688011112042f;

struct EpiIn {
    static constexpr bool PERM = true, AFTER_DRAIN = false;
    bf16_t* qkv; bf16_t* gates; const float* bgate; const float* rope;
    __device__ __forceinline__ void operator()(const f32x4 (&acc)[2][2][4][2], const Unit& u, int wr, int wc, int fr, int fq) const {
        asm volatile("" : "+v"(fr), "+v"(fq));
        const int row0 = u.pm * BM + wr * 64 + fr;
#pragma unroll
        for (int bj = 0; bj < 2; ++bj) {
            const int cbase = u.pn * BM + bj * HALF;
            const int col0 = cbase + wc * 32 + 8 * fq;
            if (cbase >= 3072) {
                const f32x4 b0 = *(const f32x4*)(bgate + (col0 - 3072)), b1 = *(const f32x4*)(bgate + (col0 - 3072) + 4);
#pragma unroll
                for (int ai = 0; ai < 2; ++ai)
#pragma unroll
                    for (int m = 0; m < 4; ++m) {
                        const f32x4 v0 = acc[ai][bj][m][0] + b0, v1 = acc[ai][bj][m][1] + b1;
                        unsigned ro = (unsigned)((row0 + ai * HALF + m * 16) * 2048 + (col0 - 3072)); asm volatile("" : "+v"(ro) :: "memory");
                        u32x4 w;
                        w.x = cvt_pk_bf16(sigmoid_f(v0[0]), sigmoid_f(v0[1])); w.y = cvt_pk_bf16(sigmoid_f(v0[2]), sigmoid_f(v0[3]));
                        w.z = cvt_pk_bf16(sigmoid_f(v1[0]), sigmoid_f(v1[1])); w.w = cvt_pk_bf16(sigmoid_f(v1[2]), sigmoid_f(v1[3]));
                        *(u32x4*)(gates + ro) = w;
                        asm volatile("" ::: "memory");
                    }
            } else {
                const bool is_v = (cbase == 640) || (cbase >= 2304);
                const bool is_q = (cbase < 512) || (cbase >= 768 && cbase < 1536);
                const float sc = is_q ? QSCALE : 1.0f;
                const bool rot = ((wc & 1) == 0) && (fq < 2);
                const float sgn = (fq == 0) ? -1.0f : 1.0f;
#pragma unroll
                for (int ai = 0; ai < 2; ++ai)
#pragma unroll
                    for (int m = 0; m < 4; ++m) {
                        int row = row0 + ai * HALF + m * 16; asm volatile("" : "+v"(row) :: "memory");
                        f32x4 v0 = acc[ai][bj][m][0], v1 = acc[ai][bj][m][1];
                        if (!is_v) {
                            f32x4 p0, p1;
#pragma unroll
                            for (int e = 0; e < 4; ++e) { p0[e] = swz_xor<16>(v0[e]); p1[e] = swz_xor<16>(v1[e]); }
                            if (rot) {
                                const float* rp = rope + (unsigned)((row & 2047) * 16);
                                const f32x4 c0 = *(const f32x4*)(rp), c1 = *(const f32x4*)(rp + 4), s0 = *(const f32x4*)(rp + 8), s1 = *(const f32x4*)(rp + 12);
                                v0 = v0 * c0 + (p0 * s0) * sgn; v1 = v1 * c1 + (p1 * s1) * sgn;
                            }
                        }
                        v0 = v0 * sc; v1 = v1 * sc;
                        u32x4 w; w.x = cvt_pk_bf16(v0[0], v0[1]); w.y = cvt_pk_bf16(v0[2], v0[3]); w.z = cvt_pk_bf16(v1[0], v1[1]); w.w = cvt_pk_bf16(v1[2], v1[3]);
                        *(u32x4*)(qkv + (unsigned)(row * 3072 + col0)) = w;
                        asm volatile("" ::: "memory");
                    }
            }
        }
    }
};

struct EpiUp {
    static constexpr bool PERM = true, AFTER_DRAIN = false;
    bf16_t* O; int ldc;
    __device__ __forceinline__ void operator()(const f32x4 (&acc)[2][2][4][2], const Unit& u, int wr, int wc, int fr, int fq) const {
        asm volatile("" : "+v"(fr), "+v"(fq));
        const int row0 = u.pm * BM + wr * 64 + fr, col0 = u.pn * BM + wc * 32 + 8 * fq;
#pragma unroll
        for (int ai = 0; ai < 2; ++ai)
#pragma unroll
            for (int m = 0; m < 4; ++m) { bf16_t* rowp = O + (size_t)(row0 + ai * HALF + m * 16) * ldc + col0;
#pragma unroll
                for (int bj = 0; bj < 2; ++bj) { f32x4 v0 = acc[ai][bj][m][0], v1 = acc[ai][bj][m][1];
#pragma unroll
                    for (int e = 0; e < 4; ++e) { const float a = fmaxf(v0[e], 0.f), b = fmaxf(v1[e], 0.f); v0[e] = a * a; v1[e] = b * b; }
                    u32x4 w; w.x = cvt_pk_bf16(v0[0], v0[1]); w.y = cvt_pk_bf16(v0[2], v0[3]); w.z = cvt_pk_bf16(v1[0], v1[1]); w.w = cvt_pk_bf16(v1[2], v1[3]);
                    *(u32x4*)(rowp + bj * HALF) = w; } }
    }
};

template <int MODE> struct EpiF {
    static constexpr bool PERM = false, AFTER_DRAIN = false;
    const float* i32; float* o32; bf16_t* ob16; const bf16_t* G; int gpitch; const float* bias; float alpha;
    __device__ __forceinline__ void operator()(const f32x4 (&acc)[2][2][4][2], const Unit& u, int wr, int wc, int fr, int fq) const {
        asm volatile("" : "+v"(fr), "+v"(fq));
        const int row0 = u.pm * BM + wr * 64 + fr, col0 = u.pn * BM + wc * 32 + 4 * fq;
        f32x4 bv[2][2];
        if constexpr (MODE == 3) {
#pragma unroll
            for (int bj = 0; bj < 2; ++bj)
#pragma unroll
                for (int n = 0; n < 2; ++n) bv[bj][n] = *(const f32x4*)(bias + col0 + bj * HALF + n * 16);
        }
#pragma unroll
        for (int ai = 0; ai < 2; ++ai)
#pragma unroll
            for (int m = 0; m < 4; ++m) {
                unsigned ro = (unsigned)((row0 + ai * HALF + m * 16) * 1024 + col0), go = (unsigned)((row0 + ai * HALF + m * 16) * gpitch + col0);
                asm volatile("" : "+v"(ro), "+v"(go) :: "memory");
                const float* ip = i32 + ro; float* op = o32 + ro; bf16_t* obp = ob16 + ro; const bf16_t* gp = G + go;
#pragma unroll
                for (int bj = 0; bj < 2; ++bj)
#pragma unroll
                    for (int n = 0; n < 2; ++n) { const int dc = bj * HALF + n * 16; f32x4 a = acc[ai][bj][m][n];
                        f32x4 g = (f32x4){1.f, 1.f, 1.f, 1.f};
                        if constexpr (MODE == 0 || MODE == 1 || MODE == 4) { const u32x2 gw = *(const u32x2*)(gp + dc); g = (f32x4){bf_lo(gw.x), bf_hi(gw.x), bf_lo(gw.y), bf_hi(gw.y)}; }
                        if constexpr (MODE == 0) { *(f32x4*)(op + dc) = g * a; }
                        if constexpr (MODE == 1) { const f32x4 t = *(const f32x4*)(ip + dc) + g * a; u32x2 w; w.x = cvt_pk_bf16(t[0], t[1]); w.y = cvt_pk_bf16(t[2], t[3]); *(u32x2*)(obp + dc) = w; }
                        if constexpr (MODE == 2) { *(f32x4*)(op + dc) = *(const f32x4*)(ip + dc) * alpha + a; }
                        if constexpr (MODE == 3) { const f32x4 t = a + bv[bj][n]; u32x2 w; w.x = cvt_pk_bf16(sigmoid_f(t[0]), sigmoid_f(t[1])); w.y = cvt_pk_bf16(sigmoid_f(t[2]), sigmoid_f(t[3])); *(u32x2*)(obp + dc) = w; }
                        if constexpr (MODE == 4) { *(f32x4*)(op + dc) = *(const f32x4*)(ip + dc) * alpha + g * a; }
                        if constexpr (MODE == 5) { *(f32x4*)(op + dc) = *(const f32x4*)(ip + dc) + a; }
                    }
                asm volatile("" ::: "memory"); }
    }
};

template <class Epi, class Sched, bool ALIGN_EPI = false, bool SP2 = false>
__device__ __forceinline__ void gemm_phase(PG8_LAS unsigned char* lds, const Gemm g, const Sched& S, const Epi& E) {
    int wv_ = g.wave; asm volatile("" : "+s"(wv_)); unsigned z_ = 0u; asm volatile("" : "+v"(z_)); int tid_ = wv_ * 64 + (int)__builtin_amdgcn_mbcnt_hi(~0u, __builtin_amdgcn_mbcnt_lo(~0u, z_)); asm volatile("" : "+v"(tid_));
    const int tid = tid_, wid = __builtin_amdgcn_readfirstlane(tid >> 6), lane = tid & 63, wr = wid >> 2, wc = wid & 3, fr = lane & 15, fq = lane >> 4;
    const int K = g.K, nt = K / BK;
    const bf16_t* gA = g.A; const bf16_t* gB = g.Bt; asm volatile("" : "+s"(gA), "+s"(gB));
    unsigned voffA[2], voffB[2];
#pragma unroll
    for (int i = 0; i < 2; ++i) { int R, C; stage_rc(tid * 16 + i * 8192, R, C); const int Rb = Epi::PERM ? ((R & ~31) + perm32(R & 31)) : R;
        voffA[i] = (unsigned)(R * K + C) * 2u; voffB[i] = (unsigned)(Rb * K + C) * 2u; }
    const size_t kstep = (size_t)(BK * 2);
    const size_t hstep = (size_t)HALF * K * 2;
    const size_t tstep = 2 * hstep;
    const unsigned ldsw = (unsigned)wid * 1024u;
    const int aoff = lds_byte(wr * 64 + fr, fq * 8), boff = lds_byte(wc * 32 + fr, fq * 8);
#define PG8_SA(b, h) (((b) * 2 + (h)) * HTB)
#define PG8_SB(b, h) ((4 + (b) * 2 + (h)) * HTB)
#define PG8_STAGE(bufoff, gbase, voff) do { _Pragma("unroll") for (int _i = 0; _i < 2; ++_i) \
        __builtin_amdgcn_global_load_lds((const unsigned*)((const char*)(gbase) + (voff)[_i]), (PG8_LAS unsigned*)(lds + (bufoff) + ldsw + _i * 8192), 16, 0, 0); } while (0)
#define PG8_LDA(dst, b, h) do { _Pragma("unroll") for (int m = 0; m < 4; ++m) _Pragma("unroll") for (int k = 0; k < 2; ++k) dst[m][k] = *(const PG8_LAS bf16x8*)(lds + PG8_SA(b, h) + aoff + m * 2048 + k * 1024); } while (0)
#define PG8_LDB(dst, b, h) do { _Pragma("unroll") for (int n = 0; n < 2; ++n) _Pragma("unroll") for (int k = 0; k < 2; ++k) dst[n][k] = *(const PG8_LAS bf16x8*)(lds + PG8_SB(b, h) + boff + n * 2048 + k * 1024); } while (0)
#define PG8_MMA(ai, bj, At, Bt) do { __builtin_amdgcn_s_setprio(1); _Pragma("unroll") for (int m = 0; m < 4; ++m) _Pragma("unroll") for (int n = 0; n < 2; ++n) _Pragma("unroll") for (int k = 0; k < 2; ++k) \
        acc[ai][bj][m][n] = __builtin_amdgcn_mfma_f32_16x16x32_bf16(Bt[n][k], At[m][k], acc[ai][bj][m][n], 0, 0, 0); __builtin_amdgcn_s_setprio(0); } while (0)
#define PG8_WAIT_V(n) asm volatile("s_waitcnt vmcnt(" #n ")" ::: "memory")
#define PG8_WAIT_L(n) asm volatile("s_waitcnt lgkmcnt(" #n ")" ::: "memory")
#define PG8_BAR __builtin_amdgcn_s_barrier()
#define PG8_SCHED __builtin_amdgcn_sched_barrier(0)
    Unit cur, nxt; int ui = 0;
    if (!S.next(0, cur)) return;
    f32x4 acc[2][2][4][2];
#pragma unroll
    for (int a = 0; a < 2; ++a)
#pragma unroll
        for (int b = 0; b < 2; ++b)
#pragma unroll
            for (int m = 0; m < 4; ++m)
#pragma unroll
                for (int n = 0; n < 2; ++n) acc[a][b][m][n] = (f32x4){0.f, 0.f, 0.f, 0.f};
    bf16x8 At[4][2], B0[2][2], B1[2][2];
    const char* cA = (const char*)gA + (size_t)cur.pm * tstep; const char* cB = (const char*)gB + (size_t)cur.pn * tstep;
    S.a_ready(cur);
    if constexpr (SP2) {
        PG8_STAGE(PG8_SB(0, 0), cB, voffB); PG8_STAGE(PG8_SB(0, 1), cB + hstep, voffB); PG8_STAGE(PG8_SA(0, 0), cA, voffA); PG8_STAGE(PG8_SA(0, 1), cA + hstep, voffA);
        if (wr == 1) PG8_BAR;
        PG8_WAIT_V(2); PG8_BAR;
        PG8_STAGE(PG8_SB(1, 0), cB + kstep, voffB); PG8_STAGE(PG8_SA(1, 0), cA + kstep, voffA); PG8_STAGE(PG8_SB(1, 1), cB + hstep + kstep, voffB);
        PG8_WAIT_V(6); PG8_BAR;
    } else {
        PG8_STAGE(PG8_SB(0, 0), cB, voffB); PG8_STAGE(PG8_SA(0, 0), cA, voffA); PG8_STAGE(PG8_SB(0, 1), cB + hstep, voffB); PG8_STAGE(PG8_SA(0, 1), cA + hstep, voffA);
        if (wr == 1) PG8_BAR;
        PG8_WAIT_V(4); PG8_BAR;
        PG8_STAGE(PG8_SB(1, 0), cB + kstep, voffB); PG8_STAGE(PG8_SA(1, 0), cA + kstep, voffA); PG8_STAGE(PG8_SB(1, 1), cB + hstep + kstep, voffB);
        PG8_WAIT_V(6); PG8_BAR;
    }
    for (;;) {
        const bool has_next = S.next(ui + 1, nxt);
        const char* nA = has_next ? (const char*)gA + (size_t)nxt.pm * tstep : cA; const char* nB = has_next ? (const char*)gB + (size_t)nxt.pn * tstep : cB;
        for (int t = 0; t < nt; t += 2) {
            const bool last = (t == nt - 2);
            const char* a1 = cA + (size_t)(t + 1) * kstep;
            const char* a2 = last ? nA : cA + (size_t)(t + 2) * kstep; const char* b2 = last ? nB : cB + (size_t)(t + 2) * kstep;
            const char* a3 = a2 + kstep; const char* b3 = b2 + kstep;
            if (last && has_next) S.a_ready(nxt);
            if constexpr (SP2) {
            PG8_LDB(B0, 0, 0); PG8_LDB(B1, 0, 1); PG8_SCHED; PG8_LDA(At, 0, 0); PG8_STAGE(PG8_SA(1, 1), a1 + hstep, voffA);
            PG8_WAIT_V(8); PG8_WAIT_L(0); PG8_BAR; PG8_MMA(0, 0, At, B0); PG8_MMA(0, 1, At, B1); PG8_BAR; PG8_SCHED;
            PG8_LDA(At, 0, 1); PG8_STAGE(PG8_SB(0, 0), b2, voffB); PG8_STAGE(PG8_SB(0, 1), b2 + hstep, voffB); PG8_STAGE(PG8_SA(0, 0), a2, voffA);
            PG8_WAIT_V(8); PG8_WAIT_L(0); PG8_BAR; PG8_MMA(1, 0, At, B0); PG8_MMA(1, 1, At, B1); PG8_BAR; PG8_SCHED;
            PG8_LDB(B0, 1, 0); PG8_LDB(B1, 1, 1); PG8_SCHED; PG8_LDA(At, 1, 0); PG8_STAGE(PG8_SA(0, 1), a2 + hstep, voffA);
            PG8_WAIT_V(8); PG8_WAIT_L(0); PG8_BAR; PG8_MMA(0, 0, At, B0); PG8_MMA(0, 1, At, B1); PG8_BAR; PG8_SCHED;
            PG8_LDA(At, 1, 1); PG8_STAGE(PG8_SB(1, 0), b3, voffB); PG8_STAGE(PG8_SB(1, 1), b3 + hstep, voffB); PG8_STAGE(PG8_SA(1, 0), a3, voffA);
            PG8_WAIT_V(8); PG8_WAIT_L(0); PG8_BAR; PG8_MMA(1, 0, At, B0); PG8_MMA(1, 1, At, B1); PG8_BAR; PG8_SCHED;
            } else {
            PG8_LDB(B0, 0, 0); PG8_SCHED; PG8_LDA(At, 0, 0); PG8_STAGE(PG8_SA(1, 1), a1 + hstep, voffA);
            PG8_WAIT_L(8); PG8_BAR; PG8_WAIT_L(0); PG8_MMA(0, 0, At, B0); PG8_BAR; PG8_SCHED;
            PG8_LDB(B1, 0, 1); PG8_STAGE(PG8_SB(0, 0), b2, voffB);
            PG8_BAR; PG8_WAIT_L(0); PG8_MMA(0, 1, At, B1); PG8_BAR;
            PG8_LDA(At, 0, 1); PG8_STAGE(PG8_SA(0, 0), a2, voffA);
            PG8_BAR; PG8_WAIT_L(0); PG8_MMA(1, 0, At, B0); PG8_BAR; PG8_SCHED;
            PG8_STAGE(PG8_SB(0, 1), b2 + hstep, voffB);
            PG8_WAIT_V(6); PG8_BAR; PG8_MMA(1, 1, At, B1); PG8_BAR;
            PG8_LDB(B0, 1, 0); PG8_SCHED; PG8_LDA(At, 1, 0); PG8_STAGE(PG8_SA(0, 1), a2 + hstep, voffA);
            PG8_WAIT_L(8); PG8_BAR; PG8_WAIT_L(0); PG8_MMA(0, 0, At, B0); PG8_BAR; PG8_SCHED;
            PG8_LDB(B1, 1, 1); PG8_STAGE(PG8_SB(1, 0), b3, voffB);
            PG8_BAR; PG8_WAIT_L(0); PG8_MMA(0, 1, At, B1); PG8_BAR;
            PG8_LDA(At, 1, 1); PG8_STAGE(PG8_SA(1, 0), a3, voffA);
            PG8_BAR; PG8_WAIT_L(0); PG8_MMA(1, 0, At, B0); PG8_BAR; PG8_SCHED;
            PG8_STAGE(PG8_SB(1, 1), b3 + hstep, voffB);
            PG8_WAIT_V(6); PG8_BAR; PG8_MMA(1, 1, At, B1); PG8_BAR;
            }
        }
        if constexpr (ALIGN_EPI) { if (wr == 0) PG8_BAR; }
        if constexpr (!Epi::AFTER_DRAIN) { E(acc, cur, wr, wc, fr, fq); S.done(cur); }
        if (!has_next) break;
#pragma unroll
        for (int a = 0; a < 2; ++a)
#pragma unroll
            for (int b = 0; b < 2; ++b)
#pragma unroll
                for (int m = 0; m < 4; ++m)
#pragma unroll
                    for (int n = 0; n < 2; ++n) acc[a][b][m][n] = (f32x4){0.f, 0.f, 0.f, 0.f};
        cur = nxt; cA = nA; cB = nB; ++ui;
        if constexpr (ALIGN_EPI) { if (wr == 1) PG8_BAR; }
    }
    PG8_WAIT_V(0);
    if constexpr (!ALIGN_EPI) { if (wr == 0) PG8_BAR; }
    PG8_BAR;
    if constexpr (Epi::AFTER_DRAIN) { E.fused(acc, cur, wr, wc, fr, fq, lds, wid, lane); S.done(cur); }
#undef PG8_SA
#undef PG8_SB
#undef PG8_STAGE
#undef PG8_LDA
#undef PG8_LDB
#undef PG8_MMA
#undef PG8_WAIT_V
#undef PG8_WAIT_L
#undef PG8_BAR
#undef PG8_SCHED
}
}

constexpr int SEQ = 2048, BATCH = 16, T = BATCH * SEQ, D = 1024, DEPTH = 4, DIN = 5120, FF = 4096, PLE = 256;
constexpr float LN_EPS = 1e-5f, ALPHA = 1.681792830507429f;
constexpr int NWAVES = 8;
constexpr size_t MiB = 1u << 20;
constexpr size_t WS_ROPE = 0;
constexpr size_t WS_BAR = 512 * 1024, BAR_BYTES = 16384;
constexpr size_t WS_LSE = 1 * MiB;
constexpr size_t WS_WT = 4 * MiB;
constexpr size_t WS_XB = 36 * MiB;
constexpr size_t WS_OA = WS_XB, WS_OB = WS_XB + 32 * MiB;
constexpr size_t WS_R = 100 * MiB;
constexpr size_t WS_QKV = WS_R, WS_GATES = WS_R + 192 * MiB;
constexpr size_t WS_MRG = WS_R, WS_TMP = WS_R + 64 * MiB;
constexpr size_t WS_HID = WS_R, WS_G = WS_R + 256 * MiB;
constexpr size_t WS_OG = 420 * MiB;
constexpr size_t WS_PB = 468 * MiB;
constexpr size_t WS_END = 484 * MiB;
constexpr size_t WT_IN = 0, WT_A = WT_IN + (size_t)DIN * D, WT_B = WT_A + (size_t)D * 512, WT_OUT = WT_B + (size_t)D * 256, WT_UP = WT_OUT + (size_t)D * D,
                 WT_DOWN = WT_UP + (size_t)FF * D, WT_PG = WT_DOWN + (size_t)D * FF, WT_PLE = WT_PG + (size_t)D * D;
static_assert((WT_PLE + (size_t)D * PLE) * 2 == 32 * MiB, "WT map");

constexpr int RING_BYTES = 131072, MISC_OFF = RING_BYTES + 320, LDS_BYTES = 147456;

#define LAS __attribute__((address_space(3)))
typedef unsigned short bf16;
typedef unsigned v4u __attribute__((ext_vector_type(4)));
typedef unsigned v2u __attribute__((ext_vector_type(2)));
typedef float f32x4 __attribute__((ext_vector_type(4)));
typedef float f32x16 __attribute__((ext_vector_type(16)));
typedef short bf16x8 __attribute__((ext_vector_type(8)));
typedef short s16x4 __attribute__((ext_vector_type(4)));
#define LDS_WAIT() asm volatile("s_waitcnt lgkmcnt(0)" ::: "memory")
__device__ __forceinline__ unsigned f2bf(float f) { unsigned u = __builtin_bit_cast(unsigned, f); return (u + 0x7fffu + ((u >> 16) & 1u)) >> 16; }
__device__ __forceinline__ unsigned pk2(float lo, float hi) { return f2bf(lo) | (f2bf(hi) << 16); }
__device__ __forceinline__ float x32_sum(float v) { const unsigned a = __builtin_bit_cast(unsigned, v); auto rr = __builtin_amdgcn_permlane32_swap(a, a, false, false); float r; asm volatile("v_add_f32_e32 %0, %1, %2" : "=v"(r) : "v"(rr[0]), "v"(rr[1])); return r; }
__device__ __forceinline__ float x32_max(float v) { const unsigned a = __builtin_bit_cast(unsigned, v); auto rr = __builtin_amdgcn_permlane32_swap(a, a, false, false); float r; asm volatile("v_max_f32_e32 %0, %1, %2" : "=v"(r) : "v"(rr[0]), "v"(rr[1])); return r; }
__device__ __forceinline__ float wave_sum(float v) {
    v += pg8::swz_xor<1>(v); v += pg8::swz_xor<2>(v); v += pg8::swz_xor<4>(v); v += pg8::swz_xor<8>(v); v += pg8::swz_xor<16>(v);
    return x32_sum(v);
}

__device__ __forceinline__ void transpose_item(const float* W, int K, int N, bf16* WT, LAS float* scr, int item, int lane) {
    const int nblk = N / 32, kb = item / nblk, nb = item % nblk, k0 = 64 * kb, n0 = 32 * nb;
#pragma unroll 8
    for (int i = 0; i < 32; ++i) { const int kk = 2 * i + (lane >> 5); scr[kk * 33 + (lane & 31)] = W[(size_t)(k0 + kk) * N + n0 + (lane & 31)]; }
    LDS_WAIT(); asm volatile("" ::: "memory");
    const int c = lane & 7;
#pragma unroll
    for (int j = 0; j < 4; ++j) { const int n = (lane >> 3) + 8 * j; const LAS float* s = scr + (8 * c) * 33 + n;
        v4u o; o.x = pk2(s[0 * 33], s[1 * 33]); o.y = pk2(s[2 * 33], s[3 * 33]); o.z = pk2(s[4 * 33], s[5 * 33]); o.w = pk2(s[6 * 33], s[7 * 33]);
        *(v4u*)(WT + (size_t)(n0 + n) * K + k0 + 8 * c) = o; }
    LDS_WAIT(); asm volatile("" ::: "memory");
}

struct Args { const float* in[17]; float* out; unsigned char* ws; };
typedef const __attribute__((address_space(4))) Args* kargs_t;
enum { I_X = 0, I_P, I_WIN, I_BGATE, I_SINK, I_WA, I_WB, I_WOUT, I_LN1G, I_LN1B, I_WUP, I_WDOWN, I_WPG, I_BPG, I_WPLE, I_LN2G, I_LN2B };

__device__ __forceinline__ void convert_layer(kargs_t a, int L, LAS float* scr, int gw, int ngw, int lane) {
    bf16* WT = (bf16*)(a->ws + WS_WT);
    constexpr int I_IN = (D / 64) * (DIN / 32), I_A = (512 / 64) * (D / 32), I_B = (256 / 64) * (D / 32), I_O = (D / 64) * (D / 32), I_U = (D / 64) * (FF / 32), I_D = (FF / 64) * (D / 32), I_G = I_O, I_E = I_B;
    constexpr int NITEMS = I_IN + I_A + I_B + I_O + I_U + I_D + I_G + I_E;
    for (int it = gw; it < NITEMS; it += ngw) {
        int r = it;
        if (r < I_IN) { transpose_item(a->in[I_WIN] + (size_t)L * D * DIN, D, DIN, WT + WT_IN, scr, r, lane); continue; } r -= I_IN;
        if (r < I_A) { transpose_item(a->in[I_WA] + (size_t)L * 512 * D, 512, D, WT + WT_A, scr, r, lane); continue; } r -= I_A;
        if (r < I_B) { transpose_item(a->in[I_WB] + (size_t)L * 256 * D, 256, D, WT + WT_B, scr, r, lane); continue; } r -= I_B;
        if (r < I_O) { transpose_item(a->in[I_WOUT] + (size_t)L * D * D, D, D, WT + WT_OUT, scr, r, lane); continue; } r -= I_O;
        if (r < I_U) { transpose_item(a->in[I_WUP] + (size_t)L * D * FF, D, FF, WT + WT_UP, scr, r, lane); continue; } r -= I_U;
        if (r < I_D) { transpose_item(a->in[I_WDOWN] + (size_t)L * FF * D, FF, D, WT + WT_DOWN, scr, r, lane); continue; } r -= I_D;
        if (r < I_G) { transpose_item(a->in[I_WPG] + (size_t)L * D * D, D, D, WT + WT_PG, scr, r, lane); continue; } r -= I_G;
        transpose_item(a->in[I_WPLE] + (size_t)L * PLE * D, PLE, D, WT + WT_PLE, scr, r, lane);
    }
    const f32x4* ps = (const f32x4*)(a->in[I_P] + (size_t)L * T * PLE); v4u* pd = (v4u*)(a->ws + WS_PB);
    const int gt = gw * 64 + lane, ngt = ngw * 64;
    for (int i = gt; i < T * PLE / 8; i += ngt) { const f32x4 v0 = ps[2 * i], v1 = ps[2 * i + 1]; v4u o; o.x = pk2(v0[0], v0[1]); o.y = pk2(v0[2], v0[3]); o.z = pk2(v1[0], v1[1]); o.w = pk2(v1[2], v1[3]); pd[i] = o; }
}

__device__ __forceinline__ void ln_row(const float* yrow, float* xrow, bf16* brow, const float* g, const float* b, int lane) {
    const f32x4* yr = (const f32x4*)yrow + lane;
    f32x4 v[4]; float s = 0.f;
#pragma unroll
    for (int j = 0; j < 4; ++j) { v[j] = yr[64 * j]; s += (v[j].x + v[j].y) + (v[j].z + v[j].w); }
    const float mean = wave_sum(s) * (1.f / D); float s2 = 0.f;
#pragma unroll
    for (int j = 0; j < 4; ++j) { v[j] = v[j] - mean; s2 += (v[j].x * v[j].x + v[j].y * v[j].y) + (v[j].z * v[j].z + v[j].w * v[j].w); }
    const float rstd = 1.f / sqrtf(wave_sum(s2) * (1.f / D) + LN_EPS);
    f32x4* xo = (f32x4*)xrow + lane; v2u* bo = (v2u*)brow + lane;
#pragma unroll
    for (int j = 0; j < 4; ++j) { const f32x4 gg = ((const f32x4*)g)[lane + 64 * j], bb = ((const f32x4*)b)[lane + 64 * j]; const f32x4 o = v[j] * rstd * gg + bb;
        xo[64 * j] = o; v2u w; w.x = pk2(o.x, o.y); w.y = pk2(o.z, o.w); bo[64 * j] = w; }
}

__device__ __forceinline__ int crow(int r, int hi) { return (r & 3) + 8 * (r >> 2) + 4 * hi; }
__device__ __forceinline__ s16x4 vtr(LAS const unsigned char* p) { return __builtin_bit_cast(s16x4, __builtin_amdgcn_ds_read_tr16_b64_v4i16((LAS s16x4*)p)); }
__device__ __forceinline__ unsigned cvtpk(float lo, float hi) { return pg8::cvt_pk_bf16(lo, hi); }

__device__ __forceinline__ void attn_unit(LAS unsigned char* wl, const bf16* __restrict__ qkv, int tok0, int rho, int r, int Lsub, int j32, int W, int qcol, int kcol, int vcol,
                                          bool has_sink, float sink2, bf16* outp, int opitch, int ocol, float* lsep, int lcol, int lane) {
    const int q = lane & 31, hh = lane >> 5;
    const int qtok = tok0 + (32 * j32 + q) * r + rho;
    bf16x8 Qf[4];
    { const bf16* qp = qkv + (size_t)qtok * 3072 + qcol + 8 * hh;
#pragma unroll
      for (int s = 0; s < 4; ++s) Qf[s] = *(const bf16x8*)(qp + 16 * s); }
    const int nch = 2 * W / 32 + 1;
    int c0 = W / 32 - j32; if (c0 < 0) c0 = 0;
    int c1 = (Lsub - 32 - 32 * j32 + W) / 32; if (c1 > nch - 1) c1 = nch - 1;
    bf16x8 Kn[4]; v4u Vn[4];
    const int vkey = lane >> 3, vch = lane & 7;
    const unsigned vdst = (unsigned)((vch >> 2) * 2048 + vkey * 64 + (vch & 3) * 16);
    const unsigned vrd = (unsigned)(((lane >> 4) & 1) * 32 + (lane & 3) * 8 + (4 * hh + ((lane & 15) >> 2)) * 64);
#define ATT_LOAD(c) do { const int ks_ = 32 * j32 - W + 32 * (c); \
        const bf16* kp_ = qkv + (size_t)(tok0 + (ks_ + q) * r + rho) * 3072 + kcol + 8 * hh; \
        _Pragma("unroll") for (int s = 0; s < 4; ++s) Kn[s] = *(const bf16x8*)(kp_ + 16 * s); \
        _Pragma("unroll") for (int i = 0; i < 4; ++i) Vn[i] = *(const v4u*)(qkv + (size_t)(tok0 + (ks_ + i * 8 + vkey) * r + rho) * 3072 + vcol + 8 * vch); } while (0)
    ATT_LOAD(c0);
    f32x16 O0, O1;
#pragma unroll
    for (int i = 0; i < 16; ++i) { O0[i] = 0.f; O1[i] = 0.f; }
    float m = -1e30f, l = 0.f;
    for (int c = c0; c <= c1; ++c) {
        bf16x8 Kf[4];
#pragma unroll
        for (int s = 0; s < 4; ++s) Kf[s] = Kn[s];
        LAS unsigned char* vb = wl + (c & 1) * 4096;
#pragma unroll
        for (int i = 0; i < 4; ++i) *(LAS v4u*)(vb + vdst + (i >> 1) * 1024 + (i & 1) * 512) = Vn[i];
        if (c < c1) ATT_LOAD(c + 1);
        f32x16 S;
#pragma unroll
        for (int i = 0; i < 16; ++i) S[i] = 0.f;
#pragma unroll
        for (int s = 0; s < 4; ++s) S = __builtin_amdgcn_mfma_f32_32x32x16_bf16(Kf[s], Qf[s], S, 0, 0, 0);
        if (c == 0) {
#pragma unroll
            for (int i = 0; i < 16; ++i) if (crow(i, hh) < q) S[i] = -1e30f;
        }
        if (c == nch - 1) {
#pragma unroll
            for (int i = 0; i < 16; ++i) if (crow(i, hh) > q) S[i] = -1e30f;
        }
        float mx = S[0];
#pragma unroll
        for (int i = 1; i < 16; ++i) mx = fmaxf(mx, S[i]);
        mx = x32_max(mx);
        const float mnew = fmaxf(m, mx), alpha = __builtin_amdgcn_exp2f(m - mnew);
        m = mnew;
        float ls = 0.f;
#pragma unroll
        for (int i = 0; i < 16; ++i) { S[i] = __builtin_amdgcn_exp2f(S[i] - mnew); ls += S[i]; }
        l = l * alpha + ls;
#pragma unroll
        for (int i = 0; i < 16; ++i) { O0[i] *= alpha; O1[i] *= alpha; }
        bf16x8 Pf[2];
#pragma unroll
        for (int s = 0; s < 2; ++s) { v4u w; w.x = cvtpk(S[8 * s + 0], S[8 * s + 1]); w.y = cvtpk(S[8 * s + 2], S[8 * s + 3]); w.z = cvtpk(S[8 * s + 4], S[8 * s + 5]); w.w = cvtpk(S[8 * s + 6], S[8 * s + 7]); Pf[s] = __builtin_bit_cast(bf16x8, w); }
#pragma unroll
        for (int s = 0; s < 2; ++s) {
            const s16x4 lo0 = vtr(vb + vrd + s * 1024), hi0 = vtr(vb + vrd + s * 1024 + 512);
            const s16x4 lo1 = vtr(vb + vrd + 2048 + s * 1024), hi1 = vtr(vb + vrd + 2048 + s * 1024 + 512);
            const bf16x8 V0 = (bf16x8){lo0[0], lo0[1], lo0[2], lo0[3], hi0[0], hi0[1], hi0[2], hi0[3]};
            const bf16x8 V1 = (bf16x8){lo1[0], lo1[1], lo1[2], lo1[3], hi1[0], hi1[1], hi1[2], hi1[3]};
            O0 = __builtin_amdgcn_mfma_f32_32x32x16_bf16(V0, Pf[s], O0, 0, 0, 0);
            O1 = __builtin_amdgcn_mfma_f32_32x32x16_bf16(V1, Pf[s], O1, 0, 0, 0);
        }
    }
#undef ATT_LOAD
    float lt = x32_sum(l);
    if (lsep != nullptr && hh == 0) lsep[(size_t)qtok * 12 + lcol] = m + __builtin_amdgcn_logf(lt);
    if (has_sink) lt += __builtin_amdgcn_exp2f(sink2 - m);
    const float inv = 1.0f / lt;
    bf16* op = outp + (size_t)qtok * opitch + ocol + 4 * hh;
#pragma unroll
    for (int g4 = 0; g4 < 4; ++g4) {
        v2u w0, w1;
        w0.x = cvtpk(O0[4 * g4 + 0] * inv, O0[4 * g4 + 1] * inv); w0.y = cvtpk(O0[4 * g4 + 2] * inv, O0[4 * g4 + 3] * inv);
        w1.x = cvtpk(O1[4 * g4 + 0] * inv, O1[4 * g4 + 1] * inv); w1.y = cvtpk(O1[4 * g4 + 2] * inv, O1[4 * g4 + 3] * inv);
        *(v2u*)(op + 8 * g4) = w0; *(v2u*)(op + 32 + 8 * g4) = w1;
    }
}

constexpr int N_ATT_A = BATCH * 8 * 64, N_ATT_B = BATCH * 12 * 64;
__device__ __forceinline__ void attn_phase(LAS unsigned char* lds, unsigned char* ws, const float* sink, int gw, int ngw, int wave, int lane) {
    LAS unsigned char* wl = lds + wave * 8192;
    const bf16* qkv = (const bf16*)(ws + WS_QKV);
    for (int u0 = gw; u0 < N_ATT_A + N_ATT_B; u0 += ngw) {
        const int u = __builtin_amdgcn_readfirstlane(u0);
        if (u < N_ATT_A) {
            const int qb = u & 63, h = (u >> 6) & 7, b = u >> 9;
            const float sink2 = sink[h] * 1.4426950408889634f;
            attn_unit(wl, qkv, b * SEQ, 0, 1, SEQ, qb, 128, 64 * h, 512 + 64 * (h >> 2), 640 + 64 * (h >> 2), true, sink2, (bf16*)(ws + WS_OA), 512, 64 * h, nullptr, 0, lane);
        } else {
            const int v = u - N_ATT_A; const int qb = v & 63, bh = v >> 6, gh = bh % 12, b = bh / 12, g = gh >> 2;
            const int r = (g == 0) ? 1 : (g == 1 ? 4 : 16), Lsub = SEQ / r, nb = Lsub / 32;
            const int rho = qb / nb, j32 = qb % nb;
            attn_unit(wl, qkv, b * SEQ, rho, r, Lsub, j32, 64, 768 + 64 * gh, 1536 + 64 * gh, 2304 + 64 * gh, false, 0.f, (bf16*)(ws + WS_OG), 768, 64 * gh, (float*)(ws + WS_LSE), gh, lane);
        }
    }
}

__device__ __forceinline__ void merge_phase(unsigned char* ws, int gt, int ngt) {
    const float* lse = (const float*)(ws + WS_LSE); const bf16* og = (const bf16*)(ws + WS_OG); bf16* ob = (bf16*)(ws + WS_OB);
    for (int i = gt; i < T * 32; i += ngt) {
        const int t = i >> 5, slot = (i >> 3) & 3, ch = i & 7;
        const float l0 = lse[(size_t)t * 12 + slot], l1 = lse[(size_t)t * 12 + 4 + slot], l2 = lse[(size_t)t * 12 + 8 + slot];
        const float mx = fmaxf(l0, fmaxf(l1, l2));
        float w0 = __builtin_amdgcn_exp2f(l0 - mx), w1 = __builtin_amdgcn_exp2f(l1 - mx), w2 = __builtin_amdgcn_exp2f(l2 - mx);
        const float inv = 1.0f / (w0 + w1 + w2); w0 *= inv; w1 *= inv; w2 *= inv;
        const bf16* p = og + (size_t)t * 768 + slot * 64 + ch * 8;
        const v4u a0 = *(const v4u*)p, a1 = *(const v4u*)(p + 256), a2 = *(const v4u*)(p + 512);
        v4u o;
#pragma unroll
        for (int e = 0; e < 4; ++e) {
            const float lo = w0 * pg8::bf_lo(a0[e]) + w1 * pg8::bf_lo(a1[e]) + w2 * pg8::bf_lo(a2[e]);
            const float hi = w0 * pg8::bf_hi(a0[e]) + w1 * pg8::bf_hi(a1[e]) + w2 * pg8::bf_hi(a2[e]);
            o[e] = pk2(lo, hi);
        }
        *(v4u*)(ob + (size_t)t * 256 + slot * 64 + ch * 8) = o;
    }
}

#define XB_TMO      128
#define XB_XCNT(j)  (256  + 64 * (j))
#define XB_XSUB(j)  (1280 + 64 * (j))
#define XB_XGEN(j)  (2304 + 64 * (j))
#define XB_TOP      3328
#define XB_TOPGEN   3392
#define XCD_BAR_WORDS 3456
#define XB_SPIN_CAP (1u << 18)

__device__ __forceinline__ unsigned xb_ld(unsigned* p)              { return __hip_atomic_load(p, __ATOMIC_RELAXED, __HIP_MEMORY_SCOPE_AGENT); }
__device__ __forceinline__ unsigned xb_add(unsigned* p, unsigned v) { return __hip_atomic_fetch_add(p, v, __ATOMIC_RELAXED, __HIP_MEMORY_SCOPE_AGENT); }
__device__ __forceinline__ unsigned xb_xcc_id() { return (unsigned)__builtin_amdgcn_s_getreg((3 << 11) | 20) & 0xFu; }
#define XB_SPIN(cond, bar) do { unsigned _sp = 0; while (cond) { __builtin_amdgcn_s_sleep(1); \
    if ((++_sp & 255u) == 0u) { if (xb_ld(&(bar)[XB_TMO])) break; if (_sp > XB_SPIN_CAP) { atomicAdd(&(bar)[XB_TMO], 1u); break; } } } } while (0)

struct XcdBarrier {
    unsigned* bar; unsigned x;
    volatile LAS unsigned* st;
};

__device__ __forceinline__ XcdBarrier xcd_barrier_post(unsigned* bar, volatile LAS unsigned* st) {
    XcdBarrier b; b.bar = bar; b.x = xb_xcc_id(); b.st = st;
    if (threadIdx.x == 0) (void)xb_add(&bar[XB_XCNT(b.x)], 1u);
    return b;
}
__device__ __forceinline__ void xcd_barrier_complete(unsigned* bar, unsigned x, unsigned& nloc, unsigned& nx) {
    const unsigned G = gridDim.x * gridDim.y * gridDim.z;
    unsigned sum, cnt, mine, sp = 0u;
    for (;;) {
        sum = 0u; cnt = 0u; mine = 0u;
#pragma unroll
        for (unsigned j = 0; j < 16; ++j) { const unsigned c = xb_ld(&bar[XB_XCNT(j)]); sum += c; cnt += (c > 0u) ? 1u : 0u; mine = (j == x) ? c : mine; }
        if (sum == G) break;
        __builtin_amdgcn_s_sleep(1);
        if ((++sp & 255u) == 0u) { if (xb_ld(&bar[XB_TMO])) break; if (sp > XB_SPIN_CAP) { atomicAdd(&bar[XB_TMO], 1u); break; } }
    }
    nloc = mine > 0u ? mine : 1u; nx = cnt > 0u ? cnt : 1u;
}

__device__ __forceinline__ void xcd_barrier(const XcdBarrier& b) {
    asm volatile("s_waitcnt vmcnt(0)" ::: "memory");
    __syncthreads();
    if (threadIdx.x == 0) {
        unsigned* bar = b.bar;
        __builtin_amdgcn_s_waitcnt(0);
        unsigned nloc = b.st[0], nx = b.st[1];
        if (nloc == 0u) { xcd_barrier_complete(bar, b.x, nloc, nx); b.st[0] = nloc; b.st[1] = nx; }
        const unsigned old = xb_add(&bar[XB_XSUB(b.x)], 1u);
        const unsigned gen = old / nloc;
        if (old + 1u == (gen + 1u) * nloc) {
            __builtin_amdgcn_fence(__ATOMIC_RELEASE, "agent");
            asm volatile("s_waitcnt vmcnt(0)" ::: "memory");
            const unsigned og = xb_add(&bar[XB_TOP], 1u);
            const unsigned tg = og / nx;
            if (og + 1u == (tg + 1u) * nx) xb_add(&bar[XB_TOPGEN], 1u);
            else XB_SPIN(xb_ld(&bar[XB_TOPGEN]) == tg, bar);
            __builtin_amdgcn_fence(__ATOMIC_ACQUIRE, "agent");
            xb_add(&bar[XB_XGEN(b.x)], 1u);
            asm volatile("s_waitcnt vmcnt(0)" ::: "memory");
        } else {
            XB_SPIN(xb_ld(&bar[XB_XGEN(b.x)]) == gen, bar);
            __builtin_amdgcn_fence(__ATOMIC_ACQUIRE, "agent");
            asm volatile("s_waitcnt vmcnt(0)" ::: "memory");
        }
    }
    __syncthreads();
}

__device__ __forceinline__ kargs_t kargs() { kargs_t p = (kargs_t)__builtin_amdgcn_kernarg_segment_ptr(); asm volatile("" : "+s"(p)); return p; }
struct Ids { int tid, lane, wave, G, gw, ngw, gt, ngt; };
__device__ __forceinline__ Ids ids(int wv) { Ids i; asm volatile("" : "+s"(wv)); unsigned z_ = 0u; asm volatile("" : "+v"(z_)); const int ln = (int)__builtin_amdgcn_mbcnt_hi(~0u, __builtin_amdgcn_mbcnt_lo(~0u, z_)); int t = wv * 64 + ln; asm volatile("" : "+v"(t)); i.tid = t; i.lane = t & 63; i.wave = wv; i.G = gridDim.x;
    i.gw = blockIdx.x * NWAVES + i.wave; i.ngw = i.G * NWAVES; i.gt = blockIdx.x * (NWAVES * 64) + t; i.ngt = i.G * NWAVES * 64; return i; }

__device__ __forceinline__ void ph_prologue(LAS unsigned char* lds, int wv) {
    const kargs_t ap = kargs(); const Ids I = ids(wv); unsigned char* ws = ap->ws;
    float* rope = (float*)(ws + WS_ROPE);
    for (int i = I.gt; i < SEQ * 8; i += I.ngt) {
        const int pos = i >> 3, k = i & 7;
        const double invf = (k == 0) ? 1.0 : (k == 1) ? 0.19392274474868576 : (k == 2) ? 0.03760603093086393 : (k == 3) ? 0.007292664737217109 : (k == 4) ? 0.001414213562373095 : (k == 5) ? 0.0002742481756762073 : (k == 6) ? 5.318295896944988e-05 : 1.031338537721246e-05;
        const double rev = (double)pos * invf * 0.15915494309189535;
        const float fr = (float)(rev - __builtin_rint(rev));
        rope[pos * 16 + k] = __builtin_amdgcn_cosf(fr); rope[pos * 16 + 8 + k] = __builtin_amdgcn_sinf(fr);
    }
    const f32x4* xs = (const f32x4*)ap->in[I_X]; v4u* xd = (v4u*)(ws + WS_XB);
    for (int i = I.gt; i < T * D / 8; i += I.ngt) { const f32x4 v0 = xs[2 * i], v1 = xs[2 * i + 1]; v4u o; o.x = pk2(v0[0], v0[1]); o.y = pk2(v0[2], v0[3]); o.z = pk2(v1[0], v1[1]); o.w = pk2(v1[2], v1[3]); xd[i] = o; }
}
__device__ __forceinline__ void ph_convert(LAS unsigned char* lds, int L, int wv) {
    const kargs_t ap = kargs(); const Ids I = ids(wv);
    convert_layer(ap, L, (LAS float*)(lds + I.wave * 16384), I.gw, I.ngw, I.lane);
}
__device__ __forceinline__ void ph_inproj(LAS unsigned char* lds, int L, int wv) {
    const kargs_t ap = kargs(); unsigned char* ws = ap->ws;
    pg8::Gemm g{(const bf16*)(ws + WS_XB), (const bf16*)(ws + WS_WT) + WT_IN, T, DIN, D, wv}; pg8::StaticOrder S; S.init(T, DIN, (int)gridDim.x, (int)blockIdx.x);
    pg8::EpiIn E{(bf16*)(ws + WS_QKV), (bf16*)(ws + WS_GATES), ap->in[I_BGATE] + L * 2048, (const float*)(ws + WS_ROPE)};
    pg8::gemm_phase<pg8::EpiIn, pg8::StaticOrder, true, true>(lds, g, S, E);
}
__device__ __forceinline__ void ph_attn(LAS unsigned char* lds, int L, int wv) {
    const kargs_t ap = kargs(); const Ids I = ids(wv);
    attn_phase(lds, ap->ws, ap->in[I_SINK] + L * 8, I.gw, I.ngw, I.wave, I.lane);
}
__device__ __forceinline__ void ph_merge(int wv) {
    const kargs_t ap = kargs(); const Ids I = ids(wv);
    merge_phase(ap->ws, I.gt, I.ngt);
}
__device__ __forceinline__ void ph_branch(LAS unsigned char* lds, int wv) {
    {
        const kargs_t ap = kargs(); unsigned char* ws = ap->ws;
        pg8::Gemm g{(const bf16*)(ws + WS_OA), (const bf16*)(ws + WS_WT) + WT_A, T, D, 512, wv}; pg8::StaticOrder S; S.init(T, D, (int)gridDim.x, (int)blockIdx.x);
        pg8::EpiF<0> E{nullptr, (float*)(ws + WS_TMP), nullptr, (const bf16*)(ws + WS_GATES), 2048, nullptr, 0.f};
        pg8::gemm_phase<pg8::EpiF<0>, pg8::StaticOrder, true, true>(lds, g, S, E);
    }
    {
        const kargs_t ap = kargs(); unsigned char* ws = ap->ws;
        pg8::Gemm g{(const bf16*)(ws + WS_OB), (const bf16*)(ws + WS_WT) + WT_B, T, D, 256, wv}; pg8::StaticOrder S; S.init(T, D, (int)gridDim.x, (int)blockIdx.x);
        pg8::EpiF<1> E{(const float*)(ws + WS_TMP), nullptr, (bf16*)(ws + WS_MRG), (const bf16*)(ws + WS_GATES) + 1024, 2048, nullptr, 0.f};
        pg8::gemm_phase<pg8::EpiF<1>, pg8::StaticOrder, true, true>(lds, g, S, E);
    }
}
__device__ __forceinline__ void ph_outproj(LAS unsigned char* lds, int L, int wv) {
    const kargs_t ap = kargs(); unsigned char* ws = ap->ws; float* out = ap->out;
    pg8::Gemm g{(const bf16*)(ws + WS_MRG), (const bf16*)(ws + WS_WT) + WT_OUT, T, D, D, wv}; pg8::StaticOrder S; S.init(T, D, (int)gridDim.x, (int)blockIdx.x);
    pg8::EpiF<2> E{L == 0 ? ap->in[I_X] : (const float*)out, out, nullptr, nullptr, 0, nullptr, ALPHA};
    pg8::gemm_phase<pg8::EpiF<2>, pg8::StaticOrder, true, true>(lds, g, S, E);
}
__device__ __forceinline__ void ph_ln(int L, int which, int wv) {
    const kargs_t ap = kargs(); const Ids I = ids(wv); float* out = ap->out; bf16* XB = (bf16*)(ap->ws + WS_XB);
    const float* g = (which == 0 ? ap->in[I_LN1G] : ap->in[I_LN2G]) + L * D; const float* b = (which == 0 ? ap->in[I_LN1B] : ap->in[I_LN2B]) + L * D;
    for (int mrow = I.gw; mrow < T; mrow += I.ngw) ln_row(out + (size_t)mrow * D, out + (size_t)mrow * D, XB + (size_t)mrow * D, g, b, I.lane);
}
__device__ __forceinline__ void ph_ple_up(LAS unsigned char* lds, int L, int wv) {
    {
        const kargs_t ap = kargs(); unsigned char* ws = ap->ws;
        pg8::Gemm g{(const bf16*)(ws + WS_XB), (const bf16*)(ws + WS_WT) + WT_PG, T, D, D, wv}; pg8::StaticOrder S; S.init(T, D, (int)gridDim.x, (int)blockIdx.x);
        pg8::EpiF<3> E{nullptr, nullptr, (bf16*)(ws + WS_G), nullptr, 0, ap->in[I_BPG] + L * D, 0.f};
        pg8::gemm_phase<pg8::EpiF<3>, pg8::StaticOrder, true, true>(lds, g, S, E);
    }
    {
        const kargs_t ap = kargs(); unsigned char* ws = ap->ws; float* out = ap->out;
        pg8::Gemm g{(const bf16*)(ws + WS_PB), (const bf16*)(ws + WS_WT) + WT_PLE, T, D, PLE, wv}; pg8::StaticOrder S; S.init(T, D, (int)gridDim.x, (int)blockIdx.x);
        pg8::EpiF<4> E{(const float*)out, out, nullptr, (const bf16*)(ws + WS_G), 1024, nullptr, ALPHA};
        pg8::gemm_phase<pg8::EpiF<4>, pg8::StaticOrder, true, true>(lds, g, S, E);
    }
    {
        const kargs_t ap = kargs(); unsigned char* ws = ap->ws;
        pg8::Gemm g{(const bf16*)(ws + WS_XB), (const bf16*)(ws + WS_WT) + WT_UP, T, FF, D, wv}; pg8::StaticOrder S; S.init(T, FF, (int)gridDim.x, (int)blockIdx.x);
        pg8::EpiUp E{(bf16*)(ws + WS_HID), FF};
        pg8::gemm_phase<pg8::EpiUp, pg8::StaticOrder, true, true>(lds, g, S, E);
    }
}
__device__ __forceinline__ void ph_down(LAS unsigned char* lds, int wv) {
    const kargs_t ap = kargs(); unsigned char* ws = ap->ws; float* out = ap->out;
    pg8::Gemm g{(const bf16*)(ws + WS_HID), (const bf16*)(ws + WS_WT) + WT_DOWN, T, D, FF, wv}; pg8::StaticOrder S; S.init(T, D, (int)gridDim.x, (int)blockIdx.x);
    pg8::EpiF<5> E{(const float*)out, out, nullptr, nullptr, 0, nullptr, 0.f};
    pg8::gemm_phase<pg8::EpiF<5>, pg8::StaticOrder, true, true>(lds, g, S, E);
}


#ifdef STOP_AFTER
__device__ __forceinline__ void dbg_dump(size_t wsoff, int pitch, int wv) {
    const kargs_t ap = kargs(); const Ids I = ids(wv); const bf16* src = (const bf16*)(ap->ws + wsoff); float* out = ap->out;
    const int cols = pitch < 1024 ? pitch : 1024;
    for (int i = I.gt; i < T * 1024; i += I.ngt) { const int t = i >> 10, c = i & 1023; float v_ = (c < cols) ? __uint_as_float((unsigned)src[(size_t)t * pitch + c] << 16) : 0.f; if (!(fabsf(v_) < 1e30f)) v_ = 777.f; out[i] = v_; }
}
#define DBG_STOP(n, off, pitch) do { if (STOP_AFTER == (n)) { if ((pitch) != 0) dbg_dump((off), (pitch), wv); return; } } while (0)
#else
#define DBG_STOP(n, off, pitch) do { } while (0)
#endif
#define GRID_SYNC() do { XcdBarrier b_; b_.bar = (unsigned*)(kargs()->ws + WS_BAR); b_.x = xb_xcc_id(); b_.st = (volatile LAS unsigned*)(lds + MISC_OFF) + 8; xcd_barrier(b_); } while (0)
__global__ void __launch_bounds__(NWAVES * 64, 2) fwd_megakernel(Args a_unused) {
    extern __shared__ __attribute__((aligned(16))) unsigned char lds_raw[];
    cg::grid_group grid = cg::this_grid();
    LAS unsigned char* lds = (LAS unsigned char*)lds_raw;
    const int wv = __builtin_amdgcn_readfirstlane((int)threadIdx.x >> 6);
    if (threadIdx.x < 32) ((LAS unsigned*)(lds + MISC_OFF))[threadIdx.x] = 0u;
    __syncthreads();
    (void)xcd_barrier_post((unsigned*)(kargs()->ws + WS_BAR), (volatile LAS unsigned*)(lds + MISC_OFF) + 8);
    ph_prologue(lds, wv);
    ph_convert(lds, 0, wv);
    GRID_SYNC();
    grid.sync();
#pragma nounroll
    for (int L = 0; L < DEPTH; ++L) {
        ph_inproj(lds, L, wv);      GRID_SYNC();
        DBG_STOP(1, WS_QKV + 4096, 3072);
        ph_attn(lds, L, wv);        GRID_SYNC();
        DBG_STOP(2, WS_OG, 768);
        ph_merge(wv);             GRID_SYNC();
        ph_branch(lds, wv);         GRID_SYNC();
        DBG_STOP(3, WS_MRG, 1024);
        ph_outproj(lds, L, wv);     GRID_SYNC();
        DBG_STOP(4, 0, 0);
        ph_ln(L, 0, wv);            GRID_SYNC();
        DBG_STOP(5, 0, 0);
        ph_ple_up(lds, L, wv);      GRID_SYNC();
        DBG_STOP(6, WS_HID, 4096);
        ph_down(lds, wv);           GRID_SYNC();
        DBG_STOP(7, 0, 0);
        ph_ln(L, 1, wv);
        if (L + 1 < DEPTH) { ph_convert(lds, L + 1, wv); GRID_SYNC(); }
    }
}

extern "C" void kernel_launch(void* const* d_in, const int* in_sizes, int n_in, void* d_out, int out_size, void* d_ws, size_t ws_size, hipStream_t stream) {
    static int grid_blocks = 0;
    if (grid_blocks == 0) {
        if (n_in != 17 || out_size != T * D || ws_size < WS_END) { fprintf(stderr, "kernel_launch: unexpected problem (n_in %d, out %d, ws %zu)\n", n_in, out_size, ws_size); grid_blocks = -1; return; }
        int dev = 0, cus = 0, per_cu = 0;
        hipGetDevice(&dev);
        hipDeviceGetAttribute(&cus, hipDeviceAttributeMultiprocessorCount, dev);
        hipFuncSetAttribute((const void*)fwd_megakernel, hipFuncAttributeMaxDynamicSharedMemorySize, LDS_BYTES);
        hipOccupancyMaxActiveBlocksPerMultiprocessor(&per_cu, (const void*)fwd_megakernel, NWAVES * 64, LDS_BYTES);
        if (per_cu < 1) { fprintf(stderr, "kernel_launch: occupancy query says %d blocks per CU\n", per_cu); per_cu = 1; }
        (void)hipGetLastError();
        grid_blocks = cus * per_cu;
    }
    if (grid_blocks < 0) return;
    if (hipMemsetAsync((char*)d_ws + WS_BAR, 0, BAR_BYTES, stream) != hipSuccess) { fprintf(stderr, "kernel_launch: memset of the barrier words failed\n"); return; }
    Args a{};
    for (int i = 0; i < 17; ++i) a.in[i] = (const float*)d_in[i];
    a.out = (float*)d_out; a.ws = (unsigned char*)d_ws;
    void* args[] = {&a};
    hipError_t e = hipLaunchCooperativeKernel((const void*)fwd_megakernel, dim3(grid_blocks), dim3(NWAVES * 64), args, LDS_BYTES, stream);
    if (e != hipSuccess) fprintf(stderr, "cooperative launch failed: %s (grid %d)\n", hipGetErrorString(e), grid_blocks);
}
```
